# Optimizing an MI355X kernel written in HIP

```python
import math
import jax, jax.numpy as jnp
from jax import lax
import numpy as np

D_MODEL = 1024
BATCH = 16
SEQ = 2048
DEPTH = 4

GRID_W = 64
CTX_LEN = 256
HEAD_DIM = 64
A_HEADS = 4
A_KV_HEADS = 2
A_WINDOW = 128
A_BLOCK = 128
B_HEADS = 4
NA_ROWS = 8
NA_COLS = 16
C_WIDTH = D_MODEL // 2
C_ORDER = 2
C_DIRS = 2
C_FILTER_WIDTH = 64
C_BANDS = 16
C_EMB = 2 * C_BANDS + 1
HYENA_TARGET = 1e-2
HYENA_FAST_DECAY = 0.3
HYENA_SLOW_DECAY = 1.5
HYENA_MIN_DECAY = math.log(HYENA_TARGET) / HYENA_SLOW_DECAY
HYENA_MAX_DECAY = math.log(HYENA_TARGET) / HYENA_FAST_DECAY
MIX_COLS = (A_HEADS * HEAD_DIM, A_KV_HEADS * HEAD_DIM, A_KV_HEADS * HEAD_DIM,
            B_HEADS * HEAD_DIM, B_HEADS * HEAD_DIM, B_HEADS * HEAD_DIM, 3 * C_WIDTH)
IN_WIDTH = sum(MIX_COLS)
MIX_WIDTH = A_HEADS * HEAD_DIM + B_HEADS * HEAD_DIM + C_WIDTH
D_FF = -(-8 * D_MODEL // (3 * 256)) * 256
ROPE_BASE = 10000.0
EPS = 1e-6
NEG_INF = -1e30

kernel_name = 'hybrid_parallel_heads_diffusion_trunk'


def _rmsnorm(x, g):
    xf = x.astype(jnp.float32)
    y = xf * lax.rsqrt(jnp.mean(xf * xf, axis=-1, keepdims=True) + EPS)
    return (y * g.astype(jnp.float32)).astype(x.dtype)


def _modulate(h, shift, scale):
    return h * (1 + scale) + shift


def _split_cols(p):
    bn, l, _ = p.shape
    offs = [int(o) for o in np.cumsum(MIX_COLS)[:-1]]
    parts = jnp.split(p, offs, axis=-1)
    qa, ka, va, qb, kb, vb = [t.reshape(bn, l, -1, HEAD_DIM) for t in parts[:6]]
    return qa, ka, va, qb, kb, vb, parts[6]


def _axial_rope(t, rows, cols):
    half = HEAD_DIM // 2
    nfreq = half // 2
    inv = ROPE_BASE ** (-jnp.arange(nfreq, dtype=jnp.float32) / nfreq)

    def rot(u, pos):
        ang = pos.astype(jnp.float32)[:, None] * inv[None, :]
        cos = jnp.cos(ang)[None, :, None, :]
        sin = jnp.sin(ang)[None, :, None, :]
        u = u.astype(jnp.float32)
        u1, u2 = u[..., :nfreq], u[..., nfreq:]
        return jnp.concatenate([u1 * cos - u2 * sin, u2 * cos + u1 * sin], axis=-1)

    out = jnp.concatenate([rot(t[..., :half], rows), rot(t[..., half:], cols)], axis=-1)
    return out.astype(t.dtype)


def _dense_attn(q, k, v, sink):
    bn, lq, hq, dh = q.shape
    hkv = k.shape[2]
    g = hq // hkv
    lk = k.shape[1]
    qg = q.reshape(bn, lq, hkv, g, dh)
    s = jnp.einsum('bqhgd,bkhd->bhgqk', qg, k).astype(jnp.float32) * (dh ** -0.5)
    if sink is not None:
        s_sink = jnp.broadcast_to(sink.astype(jnp.float32).reshape(hkv, g, 1, 1), (bn, hkv, g, lq, 1))
        s = jnp.concatenate([s, s_sink], axis=-1)
    p = jax.nn.softmax(s, axis=-1)[..., :lk].astype(v.dtype)
    return jnp.einsum('bhgqk,bkhd->bqhgd', p, v).reshape(bn, lq, hq * dh)


def _window_attn(q, k, v, kc, vc, sink):
    bn, l, hq, dh = q.shape
    hkv = k.shape[2]
    g = hq // hkv
    nb = l // A_BLOCK
    qb = q.reshape(bn, nb, A_BLOCK, hkv, g, dh)

    def band(t):
        tp = jnp.pad(t, ((0, 0), (A_BLOCK, A_BLOCK), (0, 0), (0, 0)))
        tp = tp.reshape(bn, nb + 2, A_BLOCK, hkv, dh)
        return jnp.concatenate([tp[:, :-2], tp[:, 1:-1], tp[:, 2:]], axis=2)

    kb, vb = band(k), band(v)
    start = jnp.arange(nb)[:, None] * A_BLOCK
    qpos = start + jnp.arange(A_BLOCK)[None, :]
    kpos = start - A_BLOCK + jnp.arange(3 * A_BLOCK)[None, :]
    ok = ((kpos >= 0) & (kpos < l))[:, None, :] & (jnp.abs(qpos[:, :, None] - kpos[:, None, :]) <= A_WINDOW)
    scale = dh ** -0.5
    s_loc = jnp.einsum('bnqhgd,bnkhd->bnhgqk', qb, kb).astype(jnp.float32) * scale
    s_loc = jnp.where(ok[None, :, None, None], s_loc, NEG_INF)
    s_ctx = jnp.einsum('bnqhgd,bchd->bnhgqc', qb, kc).astype(jnp.float32) * scale
    s_sink = jnp.broadcast_to(sink.astype(jnp.float32).reshape(hkv, g, 1, 1), (bn, nb, hkv, g, A_BLOCK, 1))
    p = jax.nn.softmax(jnp.concatenate([s_loc, s_ctx, s_sink], axis=-1), axis=-1).astype(v.dtype)
    nloc = 3 * A_BLOCK
    nctx = kc.shape[1]
    out = (jnp.einsum('bnhgqk,bnkhd->bnqhgd', p[..., :nloc], vb)
           + jnp.einsum('bnhgqc,bchd->bnqhgd', p[..., nloc:nloc + nctx], vc))
    return out.reshape(bn, l, hq * dh)


def _neighbourhood_attn(q, k, v, kc, vc, rpb):
    bn, l, h, dh = q.shape
    rows = l // GRID_W
    kh = min(NA_ROWS, rows)
    qg = q.reshape(bn, rows, GRID_W, h, dh)
    kg = k.reshape(bn, rows, GRID_W, h, dh)
    vg = v.reshape(bn, rows, GRID_W, h, dh)
    r = jnp.arange(rows)
    row_start = jnp.clip(r - kh // 2, 0, rows - kh)
    row_idx = row_start[:, None] + jnp.arange(kh)[None, :]
    k_slab = jnp.take(kg, row_idx, axis=1)
    v_slab = jnp.take(vg, row_idx, axis=1)
    col = jnp.arange(GRID_W)
    col_start = jnp.clip(col - NA_COLS // 2, 0, GRID_W - NA_COLS)
    col_ok = (col[None, :] >= col_start[:, None]) & (col[None, :] < col_start[:, None] + NA_COLS)
    dr = row_idx - r[:, None] + NA_ROWS - 1
    dc = jnp.clip(col[None, :] - col[:, None], 1 - NA_COLS, NA_COLS - 1) + NA_COLS - 1
    bias = rpb[:, dr[:, None, :, None], dc[None, :, None, :]]
    bias = jnp.transpose(bias, (1, 0, 2, 3, 4)).astype(jnp.float32)
    scale = dh ** -0.5
    s_loc = jnp.einsum('brqhd,brkwhd->brhqkw', qg, k_slab).astype(jnp.float32) * scale + bias[None]
    s_loc = jnp.where(col_ok[:, None, :], s_loc, NEG_INF)
    nloc = kh * GRID_W
    s_loc = s_loc.reshape(bn, rows, h, GRID_W, nloc)
    s_ctx = jnp.einsum('brqhd,bchd->brhqc', qg, kc).astype(jnp.float32) * scale
    p = jax.nn.softmax(jnp.concatenate([s_loc, s_ctx], axis=-1), axis=-1).astype(v.dtype)
    p_loc = p[..., :nloc].reshape(bn, rows, h, GRID_W, kh, GRID_W)
    out = (jnp.einsum('brhqkw,brkwhd->brqhd', p_loc, v_slab)
           + jnp.einsum('brhqc,bchd->brqhd', p[..., nloc:], vc))
    return out.reshape(bn, l, h * dh)


def _hyena_kernels(l, w1, b1, freq, w2, b2, w3):
    t = jnp.linspace(0.0, 1.0, l, dtype=jnp.float32)[:, None]
    w = 2.0 * math.pi * jnp.arange(l, dtype=jnp.float32)[:, None] / l
    f = jnp.linspace(1e-4, C_BANDS - 1, C_BANDS, dtype=jnp.float32)[None, :]
    z = jnp.concatenate([t, jnp.cos(w * f), -jnp.sin(w * f)], axis=-1)
    freq = freq.astype(jnp.float32)
    hid = jnp.sin(freq * (z @ w1.astype(jnp.float32) + b1.astype(jnp.float32)))
    hid = jnp.sin(freq * (hid @ w2.astype(jnp.float32) + b2.astype(jnp.float32)))
    hf = (hid @ w3.astype(jnp.float32)).reshape(l, C_ORDER, C_DIRS, C_WIDTH)
    deltas = jnp.abs(jnp.linspace(HYENA_MIN_DECAY, HYENA_MAX_DECAY, C_WIDTH, dtype=jnp.float32))
    hf = hf * jnp.exp(-t[:, :, None, None] * deltas)
    kern = jnp.concatenate([hf[:, :, 0], jnp.zeros((1, C_ORDER, C_WIDTH), jnp.float32), hf[:0:-1, :, 1]], axis=0)
    kern = kern / jnp.sum(jnp.abs(kern), axis=0, keepdims=True)
    return jnp.fft.rfft(kern, axis=0)


def _long_conv(u, kf, d):
    l = u.shape[1]
    uf = u.astype(jnp.float32)
    y = jnp.fft.irfft(jnp.fft.rfft(uf, n=2 * l, axis=1) * kf[None], n=2 * l, axis=1)[:, :l]
    return (y + uf * d.astype(jnp.float32)).astype(u.dtype)


def _short_conv(u, w, b):
    up = jnp.pad(u, ((0, 0), (1, 1), (0, 0)))
    return up[:, :-2] * w[0] + up[:, 1:-1] * w[1] + up[:, 2:] * w[2] + b


def _hyena(u, conv_w, conv_b, kf, d):
    u = _short_conv(u, conv_w, conv_b)
    v, x1, x2 = u[..., :C_WIDTH], u[..., C_WIDTH:2 * C_WIDTH], u[..., 2 * C_WIDTH:]
    z = x1 * _long_conv(v, kf[:, 0], d[0])
    return x2 * _long_conv(z, kf[:, 1], d[1])


def _swiglu(h, wg, wu, wd):
    return (jax.nn.silu(h @ wg) * (h @ wu)) @ wd


def setup_inputs(seed: int = 0) -> dict:
    key = jax.random.key(seed)
    ks = jax.random.split(key, 28)

    def nrm(k, shape, scale):
        return scale * jax.random.normal(k, shape, jnp.float32)

    def gain(k, shape):
        return 1.0 + nrm(k, shape, 0.02)

    return {
        'x': nrm(ks[0], (BATCH, SEQ, D_MODEL), 1.0),
        'c': nrm(ks[1], (BATCH, D_MODEL), 1.0),
        'ctx': nrm(ks[2], (BATCH, CTX_LEN, D_MODEL), 1.0),
        'c_ctx': nrm(ks[3], (D_MODEL,), 1.0),
        'ada_w': nrm(ks[4], (DEPTH, D_MODEL, 6 * D_MODEL), 0.5 * D_MODEL ** -0.5),
        'ada_b': nrm(ks[5], (DEPTH, 6 * D_MODEL), 0.01),
        'norm1_g': gain(ks[6], (DEPTH, D_MODEL)),
        'norm2_g': gain(ks[7], (DEPTH, D_MODEL)),
        'w_in': nrm(ks[8], (DEPTH, D_MODEL, IN_WIDTH), D_MODEL ** -0.5),
        'qnorm_a': gain(ks[9], (DEPTH, HEAD_DIM)),
        'knorm_a': gain(ks[10], (DEPTH, HEAD_DIM)),
        'sink_a': nrm(ks[11], (DEPTH, A_HEADS), 0.5),
        'qnorm_b': gain(ks[12], (DEPTH, HEAD_DIM)),
        'knorm_b': gain(ks[13], (DEPTH, HEAD_DIM)),
        'rpb_b': nrm(ks[14], (DEPTH, B_HEADS, 2 * NA_ROWS - 1, 2 * NA_COLS - 1), 0.1),
        'conv_w': nrm(ks[15], (DEPTH, 3, 3 * C_WIDTH), 3 ** -0.5),
        'conv_b': nrm(ks[16], (DEPTH, 3 * C_WIDTH), 0.01),
        'filt_w1': nrm(ks[17], (DEPTH, C_EMB, C_FILTER_WIDTH), C_EMB ** -0.5),
        'filt_b1': nrm(ks[18], (DEPTH, C_FILTER_WIDTH), 0.1),
        'filt_freq': 1.0 + nrm(ks[19], (DEPTH, C_FILTER_WIDTH), 0.1),
        'filt_w2': nrm(ks[20], (DEPTH, C_FILTER_WIDTH, C_FILTER_WIDTH), C_FILTER_WIDTH ** -0.5),
        'filt_b2': nrm(ks[21], (DEPTH, C_FILTER_WIDTH), 0.1),
        'filt_w3': nrm(ks[22], (DEPTH, C_FILTER_WIDTH, C_ORDER * C_DIRS * C_WIDTH), C_FILTER_WIDTH ** -0.5),
        'hyena_bias': nrm(ks[23], (DEPTH, C_ORDER, C_WIDTH), 1.0),
        'w_out': nrm(ks[24], (DEPTH, MIX_WIDTH, D_MODEL), MIX_WIDTH ** -0.5),
        'ffn_w_gate': nrm(ks[25], (DEPTH, D_MODEL, D_FF), D_MODEL ** -0.5),
        'ffn_w_up': nrm(ks[26], (DEPTH, D_MODEL, D_FF), D_MODEL ** -0.5),
        'ffn_w_down': nrm(ks[27], (DEPTH, D_FF, D_MODEL), D_FF ** -0.5),
    }


def reference(x, c, ctx, c_ctx, ada_w, ada_b, norm1_g, norm2_g, w_in, qnorm_a, knorm_a, sink_a,
              qnorm_b, knorm_b, rpb_b, conv_w, conv_b, filt_w1, filt_b1, filt_freq, filt_w2, filt_b2,
              filt_w3, hyena_bias, w_out, ffn_w_gate, ffn_w_up, ffn_w_down):
    l = x.shape[1]
    lc = ctx.shape[1]
    pos = jnp.arange(l)
    rows, cols = pos // GRID_W, pos % GRID_W
    sc = jax.nn.silu(c)
    sc_ctx = jax.nn.silu(c_ctx)
    xc = ctx
    for i in range(DEPTH):
        last = i == DEPTH - 1
        mod = (sc @ ada_w[i] + ada_b[i])[:, None, :]
        mod_c = sc_ctx @ ada_w[i] + ada_b[i]
        sh1, s1, g1, sh2, s2, g2 = jnp.split(mod, 6, axis=-1)
        ch1, cs1, cg1, ch2, cs2, cg2 = jnp.split(mod_c, 6, axis=-1)

        h = _modulate(_rmsnorm(x, norm1_g[i]), sh1, s1) @ w_in[i]
        hc = _modulate(_rmsnorm(xc, norm1_g[i]), ch1, cs1) @ w_in[i]
        qa, ka, va, qb, kb, vb, hy = _split_cols(h)
        qa_c, ka_c, va_c, qb_c, kb_c, vb_c, hy_c = _split_cols(hc)
        qa = _axial_rope(_rmsnorm(qa, qnorm_a[i]), rows, cols)
        ka = _axial_rope(_rmsnorm(ka, knorm_a[i]), rows, cols)
        qb = _rmsnorm(qb, qnorm_b[i])
        kb = _rmsnorm(kb, knorm_b[i])
        ka_c = _rmsnorm(ka_c, knorm_a[i])
        kb_c = _rmsnorm(kb_c, knorm_b[i])
        kf = _hyena_kernels(l, filt_w1[i], filt_b1[i], filt_freq[i], filt_w2[i], filt_b2[i], filt_w3[i])
        out_a = _window_attn(qa, ka, va, ka_c, va_c, sink_a[i])
        out_b = _neighbourhood_attn(qb, kb, vb, kb_c, vb_c, rpb_b[i])
        out_c = _hyena(hy, conv_w[i], conv_b[i], kf, hyena_bias[i])
        x = x + g1 * (jnp.concatenate([out_a, out_b, out_c], axis=-1) @ w_out[i])
        x = x + g2 * _swiglu(_modulate(_rmsnorm(x, norm2_g[i]), sh2, s2), ffn_w_gate[i], ffn_w_up[i], ffn_w_down[i])

        if not last:
            qa_c = _rmsnorm(qa_c, qnorm_a[i])
            qb_c = _rmsnorm(qb_c, qnorm_b[i])
            kf_c = _hyena_kernels(lc, filt_w1[i], filt_b1[i], filt_freq[i], filt_w2[i], filt_b2[i], filt_w3[i])
            oa_c = _dense_attn(qa_c, ka_c, va_c, sink_a[i])
            ob_c = _dense_attn(qb_c, kb_c, vb_c, None)
            oc_c = _hyena(hy_c, conv_w[i], conv_b[i], kf_c, hyena_bias[i])
            xc = xc + cg1 * (jnp.concatenate([oa_c, ob_c, oc_c], axis=-1) @ w_out[i])
            xc = xc + cg2 * _swiglu(_modulate(_rmsnorm(xc, norm2_g[i]), ch2, cs2), ffn_w_gate[i], ffn_w_up[i], ffn_w_down[i])
    return x
```

```cpp
#include <hip/hip_runtime.h>
#include <hip/hip_cooperative_groups.h>
#include <cstdio>
#include <cstdint>
namespace cg = cooperative_groups;

#define LAS __attribute__((address_space(3)))
typedef unsigned short bf16_t;
typedef short bf16x8 __attribute__((ext_vector_type(8)));
typedef float f32x4 __attribute__((ext_vector_type(4)));
typedef unsigned u32x4 __attribute__((ext_vector_type(4)));
typedef unsigned u32x2 __attribute__((ext_vector_type(2)));

constexpr int DM = 1024, NB = 16, SEQ = 2048, DEPTH = 4, CTXL = 256;
constexpr int NLAT = NB * SEQ, NCTX = NB * CTXL, MTOK = NLAT + NCTX;
constexpr int QKVW = 1280, HYW = 1536, CWID = 512, DFF = 2816, INW = 2816;
constexpr int MODW = 6 * DM;
constexpr float LOG2E = 1.4426950408889634f;

constexpr size_t MiB = 1u << 20;
constexpr size_t LAYER_W = 24 * MiB;
constexpr size_t W_IN = 0, W_OUT = (size_t)INW * DM * 2, W_GU = W_OUT + (size_t)DM * DM * 2, W_DN = W_GU + (size_t)2 * DFF * DM * 2;
static_assert(W_DN + (size_t)DM * DFF * 2 == LAYER_W, "layer weights");
constexpr size_t WS_WT = 0;
constexpr size_t WS_CTXX = 96 * MiB;
constexpr size_t WS_A1 = 112 * MiB;
constexpr size_t WS_A2 = 184 * MiB;
constexpr size_t WS_HYT = WS_A2 + (size_t)MTOK * QKVW * 2;
constexpr size_t WS_HYO = 382 * MiB;
constexpr size_t WS_RFL = 418 * MiB;
constexpr size_t WS_RFC = 434 * MiB;
constexpr size_t WS_MOD = 436 * MiB;
constexpr size_t WS_HID = 438 * MiB;
constexpr size_t WS_PART = 441 * MiB;
constexpr size_t WS_ROPE = 443 * MiB;
constexpr size_t WS_END = 444 * MiB;
static_assert(WS_HYT + (size_t)HYW * MTOK * 2 <= WS_HYO && WS_A2 + (size_t)MTOK * DFF * 2 <= WS_HYO, "A2");

constexpr int LDS_BYTES = 139264;

__device__ __forceinline__ unsigned f2bf(float f) { unsigned u = __builtin_bit_cast(unsigned, f); return (u + 0x7fffu + ((u >> 16) & 1u)) >> 16; }
__device__ __forceinline__ unsigned pk2(float lo, float hi) { return f2bf(lo) | (f2bf(hi) << 16); }
__device__ __forceinline__ float bf2f(unsigned h) { return __builtin_bit_cast(float, h << 16); }
__device__ __forceinline__ float bflo(unsigned w) { return __builtin_bit_cast(float, w << 16); }
__device__ __forceinline__ float bfhi(unsigned w) { return __builtin_bit_cast(float, w & 0xffff0000u); }
__device__ __forceinline__ float wave_sum(float v) {
#pragma unroll
    for (int o = 1; o < 64; o <<= 1) v += __shfl_xor(v, o);
    return v;
}

namespace pg8 {
constexpr int BM = 256, BK = 64, HALF = 128, HTB = HALF * BK * 2, NXCD = 8, WGM = 8;
__device__ __forceinline__ int lds_byte(int r, int c) { const int st = (r >> 4) * 2 + (c >> 5), rr = r & 15, cc = c & 31, ob = rr * 64 + cc * 2; return st * 1024 + (ob ^ (((ob >> 9) & 1) << 5)); }
__device__ __forceinline__ void stage_rc(int b, int& R, int& C) { const int st = b / 1024, sb = b % 1024, swz = sb ^ (((sb >> 9) & 1) << 5); R = (st >> 1) * 16 + swz / 64; C = (st & 1) * 32 + (swz % 64) / 2; }
__device__ __forceinline__ int perm32(int rho) { const int n = rho >> 4, i = rho & 15; return 8 * (i >> 2) + 4 * n + (i & 3); }

struct Unit { int pm, pn, which; };

__device__ __forceinline__ void map_unit(int wgid, int nM, int nN, Unit& u) {
    const int nwg = nM * nN;
    { const int q = nwg / NXCD, r = nwg % NXCD, xcd = wgid % NXCD, off = wgid / NXCD; wgid = (xcd < r ? xcd * (q + 1) : r * (q + 1) + (xcd - r) * q) + off; }
    const int nig = WGM * nN, gid = wgid / nig, fm = gid * WGM, gsz = (nM - fm) < WGM ? (nM - fm) : WGM;
    u.pm = fm + ((wgid % nig) % gsz); u.pn = (wgid % nig) / gsz;
}
struct Sched2 {
    const char* A0; const char* B0; const char* A1; const char* B1;
    int nM0, nN0, nM1, nN1, n0, n1, G, c, K;
    __device__ __forceinline__ bool next(int i, Unit& u) const {
        const int L = i * G + c;
        if (L < n0) { u.which = 0; map_unit(L, nM0, nN0, u); return true; }
        if (L < n0 + n1) { u.which = 1; map_unit(L - n0, nM1, nN1, u); return true; }
        return false;
    }
    __device__ __forceinline__ const char* aptr(const Unit& u) const { return (u.which ? A1 : A0) + (size_t)u.pm * ((size_t)BM * K * 2); }
    __device__ __forceinline__ const char* bptr(const Unit& u) const { return (u.which ? B1 : B0) + (size_t)u.pn * ((size_t)BM * K * 2); }
};

template <class Epi, bool ALIGN_EPI>
__device__ __forceinline__ void gemm_phase(LAS unsigned char* lds, const Sched2& S, const Epi& E) {
    int tid = threadIdx.x; asm volatile("" : "+v"(tid));
    const int wid = __builtin_amdgcn_readfirstlane(tid >> 6), lane = tid & 63, wr = wid >> 2, wc = wid & 3, fr = lane & 15, fq = lane >> 4;
    const int K = S.K, nt = K / BK;
    unsigned voffA[2], voffB[2];
#pragma unroll
    for (int i = 0; i < 2; ++i) { int R, C; stage_rc(tid * 16 + i * 8192, R, C); const int Rb = (R & ~31) + perm32(R & 31);
        voffA[i] = (unsigned)(R * K + C) * 2u; voffB[i] = (unsigned)(Rb * K + C) * 2u; }
    const size_t kstep = (size_t)(BK * 2);
    const size_t hstep = (size_t)HALF * K * 2;
    const unsigned ldsw = (unsigned)wid * 1024u;
    const int aoff = lds_byte(wr * 64 + fr, fq * 8), boff = lds_byte(wc * 32 + fr, fq * 8);
#define PG8_SA(b, h) (((b) * 2 + (h)) * HTB)
#define PG8_SB(b, h) ((4 + (b) * 2 + (h)) * HTB)
#define PG8_STAGE(bufoff, gbase, voff) do { _Pragma("unroll") for (int _i = 0; _i < 2; ++_i) \
        __builtin_amdgcn_global_load_lds((const unsigned*)((const char*)(gbase) + (voff)[_i]), (LAS unsigned*)(lds + (bufoff) + ldsw + _i * 8192), 16, 0, 0); } while (0)
#define PG8_LDA(dst, b, h) do { _Pragma("unroll") for (int m = 0; m < 4; ++m) _Pragma("unroll") for (int k = 0; k < 2; ++k) dst[m][k] = *(const LAS bf16x8*)(lds + PG8_SA(b, h) + aoff + m * 2048 + k * 1024); } while (0)
#define PG8_LDB(dst, b, h) do { _Pragma("unroll") for (int n = 0; n < 2; ++n) _Pragma("unroll") for (int k = 0; k < 2; ++k) dst[n][k] = *(const LAS bf16x8*)(lds + PG8_SB(b, h) + boff + n * 2048 + k * 1024); } while (0)
#define PG8_MMA(ai, bj, At, Bt) do { __builtin_amdgcn_s_setprio(1); _Pragma("unroll") for (int m = 0; m < 4; ++m) _Pragma("unroll") for (int n = 0; n < 2; ++n) _Pragma("unroll") for (int k = 0; k < 2; ++k) \
        acc[ai][bj][m][n] = __builtin_amdgcn_mfma_f32_16x16x32_bf16(Bt[n][k], At[m][k], acc[ai][bj][m][n], 0, 0, 0); __builtin_amdgcn_s_setprio(0); } while (0)
#define PG8_WAIT_V(n) asm volatile("s_waitcnt vmcnt(" #n ")" ::: "memory")
#define PG8_WAIT_L(n) asm volatile("s_waitcnt lgkmcnt(" #n ")" ::: "memory")
#define PG8_BAR __builtin_amdgcn_s_barrier()
#define PG8_SCHED __builtin_amdgcn_sched_barrier(0)
    Unit cur, nxt; int ui = 0;
    if (!S.next(0, cur)) return;
    f32x4 acc[2][2][4][2];
#pragma unroll
    for (int a = 0; a < 2; ++a)
#pragma unroll
        for (int b = 0; b < 2; ++b)
#pragma unroll
            for (int m = 0; m < 4; ++m)
#pragma unroll
                for (int n = 0; n < 2; ++n) acc[a][b][m][n] = (f32x4){0.f, 0.f, 0.f, 0.f};
    bf16x8 At[4][2], B0[2][2], B1[2][2];
    const char* cA = S.aptr(cur); const char* cB = S.bptr(cur);
    PG8_STAGE(PG8_SB(0, 0), cB, voffB); PG8_STAGE(PG8_SB(0, 1), cB + hstep, voffB); PG8_STAGE(PG8_SA(0, 0), cA, voffA); PG8_STAGE(PG8_SA(0, 1), cA + hstep, voffA);
    if (wr == 1) PG8_BAR;
    PG8_WAIT_V(2); PG8_BAR;
    PG8_STAGE(PG8_SB(1, 0), cB + kstep, voffB); PG8_STAGE(PG8_SA(1, 0), cA + kstep, voffA); PG8_STAGE(PG8_SB(1, 1), cB + hstep + kstep, voffB);
    PG8_WAIT_V(6); PG8_BAR;
    for (;;) {
        const bool has_next = S.next(ui + 1, nxt);
        const char* nA = has_next ? S.aptr(nxt) : cA; const char* nB = has_next ? S.bptr(nxt) : cB;
        for (int t = 0; t < nt; t += 2) {
            const bool last = (t == nt - 2);
            const char* a1 = cA + (size_t)(t + 1) * kstep;
            const char* a2 = last ? nA : cA + (size_t)(t + 2) * kstep; const char* b2 = last ? nB : cB + (size_t)(t + 2) * kstep;
            const char* a3 = a2 + kstep; const char* b3 = b2 + kstep;
            PG8_LDB(B0, 0, 0); PG8_LDB(B1, 0, 1); PG8_SCHED; PG8_LDA(At, 0, 0); PG8_STAGE(PG8_SA(1, 1), a1 + hstep, voffA);
            PG8_WAIT_V(8); PG8_WAIT_L(0); PG8_BAR; PG8_MMA(0, 0, At, B0); PG8_MMA(0, 1, At, B1); PG8_BAR; PG8_SCHED;
            PG8_LDA(At, 0, 1); PG8_STAGE(PG8_SB(0, 0), b2, voffB); PG8_STAGE(PG8_SB(0, 1), b2 + hstep, voffB); PG8_STAGE(PG8_SA(0, 0), a2, voffA);
            PG8_WAIT_V(8); PG8_WAIT_L(0); PG8_BAR; PG8_MMA(1, 0, At, B0); PG8_MMA(1, 1, At, B1); PG8_BAR; PG8_SCHED;
            PG8_LDB(B0, 1, 0); PG8_LDB(B1, 1, 1); PG8_SCHED; PG8_LDA(At, 1, 0); PG8_STAGE(PG8_SA(0, 1), a2 + hstep, voffA);
            PG8_WAIT_V(8); PG8_WAIT_L(0); PG8_BAR; PG8_MMA(0, 0, At, B0); PG8_MMA(0, 1, At, B1); PG8_BAR; PG8_SCHED;
            PG8_LDA(At, 1, 1); PG8_STAGE(PG8_SB(1, 0), b3, voffB); PG8_STAGE(PG8_SB(1, 1), b3 + hstep, voffB); PG8_STAGE(PG8_SA(1, 0), a3, voffA);
            PG8_WAIT_V(8); PG8_WAIT_L(0); PG8_BAR; PG8_MMA(1, 0, At, B0); PG8_MMA(1, 1, At, B1); PG8_BAR; PG8_SCHED;
        }
        if constexpr (ALIGN_EPI) { if (wr == 0) PG8_BAR; }
        E(acc, cur, wr, wc, fr, fq);
        if (!has_next) break;
#pragma unroll
        for (int a = 0; a < 2; ++a)
#pragma unroll
            for (int b = 0; b < 2; ++b)
#pragma unroll
                for (int m = 0; m < 4; ++m)
#pragma unroll
                    for (int n = 0; n < 2; ++n) acc[a][b][m][n] = (f32x4){0.f, 0.f, 0.f, 0.f};
        cur = nxt; cA = nA; cB = nB; ++ui;
        if constexpr (ALIGN_EPI) { if (wr == 1) PG8_BAR; }
    }
    PG8_WAIT_V(0);
    if constexpr (!ALIGN_EPI) { if (wr == 0) PG8_BAR; }
    PG8_BAR;
#undef PG8_SA
#undef PG8_SB
#undef PG8_STAGE
#undef PG8_LDA
#undef PG8_LDB
#undef PG8_MMA
#undef PG8_WAIT_V
#undef PG8_WAIT_L
#undef PG8_BAR
#undef PG8_SCHED
}

struct EpiIn {
    bf16_t* O0; int ld0; bf16_t* O1; int ld1;
    __device__ __forceinline__ void operator()(const f32x4 (&acc)[2][2][4][2], const Unit& u, int wr, int wc, int fr, int fq) const {
        bf16_t* base = u.which ? O1 : O0; const int ldc = u.which ? ld1 : ld0;
        const int row0 = u.pm * BM + wr * 64 + fr, col0 = u.pn * BM + wc * 32 + 8 * fq;
#pragma unroll
        for (int ai = 0; ai < 2; ++ai)
#pragma unroll
            for (int m = 0; m < 4; ++m) { bf16_t* rowp = base + (size_t)(row0 + ai * HALF + m * 16) * ldc + col0;
#pragma unroll
                for (int bj = 0; bj < 2; ++bj) { const f32x4 v0 = acc[ai][bj][m][0], v1 = acc[ai][bj][m][1];
                    u32x4 w; w.x = pk2(v0[0], v0[1]); w.y = pk2(v0[2], v0[3]); w.z = pk2(v1[0], v1[1]); w.w = pk2(v1[2], v1[3]);
                    *(u32x4*)(rowp + bj * HALF) = w; } }
    }
};
struct EpiRes {
    const float* srcL; const float* srcC; float* dstL; float* dstC; const float* gate;
    __device__ __forceinline__ void operator()(const f32x4 (&acc)[2][2][4][2], const Unit& u, int wr, int wc, int fr, int fq) const {
        const int row0 = u.pm * BM + wr * 64 + fr, col0 = u.pn * BM + wc * 32 + 8 * fq;
#pragma unroll
        for (int ai = 0; ai < 2; ++ai)
#pragma unroll
            for (int m = 0; m < 4; ++m) {
                const int row = row0 + ai * HALF + m * 16; const bool lat = row < NLAT;
                const size_t ro = lat ? (size_t)row * DM : (size_t)(row - NLAT) * DM;
                const float* sp = (lat ? srcL : srcC) + ro + col0; float* dp = (lat ? dstL : dstC) + ro + col0;
                const float* gp = gate + (size_t)(lat ? (row >> 11) : 16) * MODW + col0;
#pragma unroll
                for (int bj = 0; bj < 2; ++bj)
#pragma unroll
                    for (int n = 0; n < 2; ++n) {
                        const f32x4 s = *(const f32x4*)(sp + bj * HALF + 4 * n), g = *(const f32x4*)(gp + bj * HALF + 4 * n);
                        *(f32x4*)(dp + bj * HALF + 4 * n) = s + g * acc[ai][bj][m][n]; }
            }
    }
};
struct EpiGU {
    bf16_t* O;
    __device__ __forceinline__ void operator()(const f32x4 (&acc)[2][2][4][2], const Unit& u, int wr, int wc, int fr, int fq) const {
        const int row0 = u.pm * BM + wr * 64 + fr, col0 = u.pn * HALF + wc * 16 + 4 * fq;
#pragma unroll
        for (int ai = 0; ai < 2; ++ai)
#pragma unroll
            for (int m = 0; m < 4; ++m) { bf16_t* rowp = O + (size_t)(row0 + ai * HALF + m * 16) * DFF + col0;
#pragma unroll
                for (int bj = 0; bj < 2; ++bj) { const f32x4 g = acc[ai][bj][m][0], v = acc[ai][bj][m][1]; float r[4];
#pragma unroll
                    for (int j = 0; j < 4; ++j) r[j] = g[j] * __builtin_amdgcn_rcpf(1.f + __expf(-g[j])) * v[j];
                    u32x2 w; w.x = pk2(r[0], r[1]); w.y = pk2(r[2], r[3]);
                    *(u32x2*)(rowp + bj * 64) = w; } }
    }
};
}

struct Args { const float* in[28]; float* out; unsigned char* ws; };
enum { I_X = 0, I_C, I_CTX, I_CCTX, I_ADAW, I_ADAB, I_N1G, I_N2G, I_WIN, I_QNA, I_KNA, I_SINK, I_QNB, I_KNB, I_RPB, I_CONVW, I_CONVB,
       I_FW1, I_FB1, I_FFREQ, I_FW2, I_FB2, I_FW3, I_HBIAS, I_WOUT, I_WG, I_WU, I_WD };

__device__ __forceinline__ void p0_transpose_item(const float* W, int K, int N, bf16_t* WT, int row_off, int mode, LAS float* scr, int item, int lane) {
    const int nblk = N / 32, kb = item / nblk, nb = item % nblk, k0 = 64 * kb, n0 = 32 * nb;
#pragma unroll 8
    for (int i = 0; i < 32; ++i) { const int kk = 2 * i + (lane >> 5); scr[kk * 33 + (lane & 31)] = W[(size_t)(k0 + kk) * N + n0 + (lane & 31)]; }
    asm volatile("s_waitcnt lgkmcnt(0)" ::: "memory");
    const int c = lane & 7;
#pragma unroll
    for (int j = 0; j < 4; ++j) { const int nl = (lane >> 3) + 8 * j; const LAS float* s = scr + (8 * c) * 33 + nl; const int n = n0 + nl;
        u32x4 o; o.x = pk2(s[0 * 33], s[1 * 33]); o.y = pk2(s[2 * 33], s[3 * 33]); o.z = pk2(s[4 * 33], s[5 * 33]); o.w = pk2(s[6 * 33], s[7 * 33]);
        const int row = mode ? (8 * (n >> 2) + (n & 3) + row_off) : (row_off + n);
        *(u32x4*)(WT + (size_t)row * K + k0 + 8 * c) = o; }
    asm volatile("s_waitcnt lgkmcnt(0)" ::: "memory");
}

__device__ __forceinline__ void phase0(const Args& a, LAS unsigned char* lds, int tid, int lane, int wave, int bid, int G) {
    { int t_ = threadIdx.x; asm volatile("" : "+v"(t_)); tid = t_; lane = t_ & 63; wave = __builtin_amdgcn_readfirstlane(t_ >> 6); }
    const int gw = bid * 8 + wave, NGW = G * 8;
    {
        LAS float* scr = (LAS float*)(lds + wave * 16384);
        constexpr int I_IN = 16 * 88, I_O = 16 * 32, I_G = 16 * 88, I_D = 44 * 32, PER = I_IN + I_O + 2 * I_G + I_D;
        for (int it = gw; it < DEPTH * PER; it += NGW) {
            const int layer = it / PER; int r = it % PER;
            unsigned char* wl = a.ws + WS_WT + (size_t)layer * LAYER_W;
            if (r < I_IN) { p0_transpose_item(a.in[I_WIN] + (size_t)layer * DM * INW, DM, INW, (bf16_t*)(wl + W_IN), 0, 0, scr, r, lane); continue; } r -= I_IN;
            if (r < I_O) { p0_transpose_item(a.in[I_WOUT] + (size_t)layer * DM * DM, DM, DM, (bf16_t*)(wl + W_OUT), 0, 0, scr, r, lane); continue; } r -= I_O;
            if (r < I_G) { p0_transpose_item(a.in[I_WG] + (size_t)layer * DM * DFF, DM, DFF, (bf16_t*)(wl + W_GU), 0, 1, scr, r, lane); continue; } r -= I_G;
            if (r < I_G) { p0_transpose_item(a.in[I_WU] + (size_t)layer * DM * DFF, DM, DFF, (bf16_t*)(wl + W_GU), 4, 1, scr, r, lane); continue; } r -= I_G;
            p0_transpose_item(a.in[I_WD] + (size_t)layer * DFF * DM, DFF, DM, (bf16_t*)(wl + W_DN), 0, 0, scr, r, lane);
        }
    }
    {
        float* hid = (float*)(a.ws + WS_HID);
        for (int task = gw; task < DEPTH * 2304; task += NGW) {
            const int layer = task / 2304, jidx = task % 2304; const bool kc = jidx >= 2048; const int L = kc ? 256 : 2048, j = kc ? jidx - 2048 : jidx;
            const float tj = (float)j / (float)(L - 1), wj = 6.283185307179586f * (float)j / (float)L;
            const float fm = 1e-4f + (float)(lane & 15) * ((15.f - 1e-4f) / 15.f);
            const float ang = wj * fm; const float cv = cosf(ang), sv = -sinf(ang);
            const float* w1 = a.in[I_FW1] + (size_t)layer * 33 * 64; const float* w2 = a.in[I_FW2] + (size_t)layer * 64 * 64;
            const float fr = a.in[I_FFREQ][layer * 64 + lane];
            float acc = tj * w1[lane] + a.in[I_FB1][layer * 64 + lane];
#pragma unroll
            for (int m2 = 0; m2 < 16; ++m2) acc += __shfl(cv, m2) * w1[(1 + m2) * 64 + lane] + __shfl(sv, m2) * w1[(17 + m2) * 64 + lane];
            const float h1 = sinf(fr * acc);
            float a2 = a.in[I_FB2][layer * 64 + lane];
#pragma unroll 8
            for (int k2 = 0; k2 < 64; ++k2) a2 += __shfl(h1, k2) * w2[k2 * 64 + lane];
            hid[((size_t)layer * 2304 + jidx) * 64 + lane] = sinf(fr * a2);
        }
    }
    {
        const int gt = bid * 512 + tid;
        if (gt < 1024) { const int pos = gt >> 4, i = gt & 15; const float inv = powf(10000.f, -(float)i / 16.f); const float ang = (float)pos * inv;
            float* tab = (float*)(a.ws + WS_ROPE); tab[2 * gt] = cosf(ang); tab[2 * gt + 1] = sinf(ang); }
    }
    {
        LAS float* sct = (LAS float*)lds; LAS float* red = (LAS float*)(lds + 81920);
        float* mod = (float*)(a.ws + WS_MOD);
        for (int unit = bid; unit < DEPTH * 96; unit += G) {
            const int layer = unit / 96, cb = unit % 96;
            __syncthreads();
            for (int idx = tid; idx < 17 * 1024; idx += 512) { const int r = idx >> 10, k = idx & 1023; const float cv = r < 16 ? a.in[I_C][r * 1024 + k] : a.in[I_CCTX][k];
                sct[k * 20 + r] = cv / (1.f + __expf(-cv)); }
            __syncthreads();
            float acc[17];
#pragma unroll
            for (int r = 0; r < 17; ++r) acc[r] = 0.f;
            const float* wp = a.in[I_ADAW] + (size_t)layer * DM * MODW + cb * 64 + lane;
            for (int k = wave * 128; k < wave * 128 + 128; ++k) {
                const float w = wp[(size_t)k * MODW];
                const LAS f32x4* sr = (const LAS f32x4*)(sct + k * 20);
                const f32x4 s0 = sr[0], s1 = sr[1], s2 = sr[2], s3 = sr[3]; const float s16 = sct[k * 20 + 16];
#pragma unroll
                for (int r = 0; r < 4; ++r) { acc[r] += s0[r] * w; acc[4 + r] += s1[r] * w; acc[8 + r] += s2[r] * w; acc[12 + r] += s3[r] * w; }
                acc[16] += s16 * w;
            }
#pragma unroll
            for (int r = 0; r < 17; ++r) red[(wave * 17 + r) * 64 + lane] = acc[r];
            __syncthreads();
            for (int idx = tid; idx < 17 * 64; idx += 512) { const int r = idx >> 6, l = idx & 63; float s = a.in[I_ADAB][layer * MODW + cb * 64 + l];
#pragma unroll
                for (int w = 0; w < 8; ++w) s += red[(w * 17 + r) * 64 + l];
                mod[((size_t)layer * 17 + r) * MODW + cb * 64 + l] = s; }
        }
        __syncthreads();
    }
}

__device__ __forceinline__ void filter_phase(const Args& a, int layer, int lane, int wave, int bid, int G) {
    { int t_ = threadIdx.x; asm volatile("" : "+v"(t_)); lane = t_ & 63; wave = __builtin_amdgcn_readfirstlane(t_ >> 6); }
    const int gw = bid * 8 + wave, NGW = G * 8;
    const float* hid = (const float*)(a.ws + WS_HID);
    const float* w3 = a.in[I_FW3] + (size_t)layer * 64 * 2048;
    float* part = (float*)(a.ws + WS_PART) + (size_t)layer * 36 * 2048;
    constexpr float DMIN = -3.0701134573253945f, DMAX = -15.350567286626973f;
    for (int task = gw; task < 36 * 64; task += NGW) {
        const int jb = task >> 6, cc = task & 63; const bool kc = jb >= 32; const int L = kc ? 256 : 2048;
        const int j = (kc ? jb - 32 : jb) * 64 + lane; const float tj = (float)j / (float)(L - 1);
        float* Rf = (float*)(a.ws + (kc ? WS_RFC : WS_RFL));
        float h[64];
        const f32x4* hp = (const f32x4*)(hid + ((size_t)layer * 2304 + jb * 64 + lane) * 64);
#pragma unroll
        for (int q = 0; q < 16; ++q) { const f32x4 v = hp[q]; h[4 * q] = v[0]; h[4 * q + 1] = v[1]; h[4 * q + 2] = v[2]; h[4 * q + 3] = v[3]; }
        for (int i = 0; i < 32; ++i) {
            const int col = cc * 32 + i, o = col >> 10, dir = (col >> 9) & 1, c = col & 511;
            float val = 0.f;
#pragma unroll
            for (int k = 0; k < 64; ++k) val += h[k] * w3[k * 2048 + col];
            const float delta = fabsf(DMIN + (float)c * ((DMAX - DMIN) / 511.f));
            val *= expf(-tj * delta);
            const bool excl = (dir == 1) && (j == 0);
            const int p = dir ? (L - 1 + j) : (L - 1 - j);
            if (!excl) Rf[((size_t)(o * 512 + c)) * (2 * L) + p] = val;
            const float s = wave_sum(excl ? 0.f : fabsf(val));
            if (lane == 0) part[jb * 2048 + col] = s;
        }
    }
}

__device__ __forceinline__ void norm_phase(const float* srcL, const float* srcC, const float* g, const float* modl, int shOff, int scOff, bf16_t* xn, int nrows,
                                           int lane, int wave, int bid, int G) {
    { int t_ = threadIdx.x; asm volatile("" : "+v"(t_)); lane = t_ & 63; wave = __builtin_amdgcn_readfirstlane(t_ >> 6); }
    const int gw = bid * 8 + wave, NGW = G * 8;
    for (int row = gw; row < nrows; row += NGW) {
        const bool lat = row < NLAT;
        const float* src = lat ? srcL + (size_t)row * DM : srcC + (size_t)(row - NLAT) * DM;
        const float* mr = modl + (size_t)(lat ? (row >> 11) : 16) * MODW;
        f32x4 v[4]; float ss = 0.f;
#pragma unroll
        for (int j = 0; j < 4; ++j) { v[j] = ((const f32x4*)src)[lane + 64 * j]; ss += v[j][0] * v[j][0] + v[j][1] * v[j][1] + v[j][2] * v[j][2] + v[j][3] * v[j][3]; }
        const float rstd = rsqrtf(wave_sum(ss) * (1.f / DM) + 1e-6f);
#pragma unroll
        for (int j = 0; j < 4; ++j) { const int col = 4 * (lane + 64 * j);
            const f32x4 gg = *(const f32x4*)(g + col), sc = *(const f32x4*)(mr + scOff + col), sh = *(const f32x4*)(mr + shOff + col);
            float y[4];
#pragma unroll
            for (int e = 0; e < 4; ++e) y[e] = v[j][e] * rstd * gg[e] * (1.f + sc[e]) + sh[e];
            u32x2 w; w.x = pk2(y[0], y[1]); w.y = pk2(y[2], y[3]);
            *(u32x2*)(xn + (size_t)row * DM + col) = w; }
    }
}

__device__ __forceinline__ void post_phase(const Args& a, int layer, bf16_t* H, int lane, int wave, int bid, int G) {
    { int t_ = threadIdx.x; asm volatile("" : "+v"(t_)); lane = t_ & 63; wave = __builtin_amdgcn_readfirstlane(t_ >> 6); }
    const int gw = bid * 8 + wave, NGW = G * 8;
    const float* tab = (const float*)(a.ws + WS_ROPE);
    const float gqa = a.in[I_QNA][layer * 64 + lane], gka = a.in[I_KNA][layer * 64 + lane], gqb = a.in[I_QNB][layer * 64 + lane], gkb = a.in[I_KNB][layer * 64 + lane];
    for (int row = gw; row < MTOK; row += NGW) {
        const bool lat = row < NLAT; const int s = row & 2047, prow = s >> 6, pcol = s & 63;
        const int pos = lane < 32 ? prow : pcol;
        const float cs = tab[(pos * 16 + (lane & 15)) * 2], sn = tab[(pos * 16 + (lane & 15)) * 2 + 1];
        bf16_t* hr = H + (size_t)row * QKVW;
#pragma unroll
        for (int hh = 0; hh < 14; ++hh) {
            const int col0 = hh < 6 ? 64 * hh : 512 + 64 * (hh - 6);
            const float gg = hh < 4 ? gqa : (hh < 6 ? gka : (hh < 10 ? gqb : gkb));
            const float x = bf2f(hr[col0 + lane]);
            float y = x * rsqrtf(wave_sum(x * x) * (1.f / 64.f) + 1e-6f) * gg;
            if (hh < 6 && lat) { const float pr = __shfl_xor(y, 16); y = (lane & 16) ? (y * cs + pr * sn) : (y * cs - pr * sn); }
            hr[col0 + lane] = (bf16_t)f2bf(y);
        }
    }
}

__device__ __forceinline__ void attn_unit(LAS unsigned char* lds, int kind, int b, int h, int qb, const bf16_t* H, bf16_t* mix, const float* sink, const float* rpb,
                                          int tid, int lane, int wave) {
    LAS unsigned char* Ks = lds; LAS unsigned char* Vt = lds + 9216; LAS float* rpbs = (LAS float*)(lds + 18432);
    const bool isA = !(kind & 1), lat = kind < 2;
    const int q0 = qb * 128;
    const int qrow0 = lat ? b * SEQ + q0 : NLAT + b * CTXL + q0;
    const int qcol = isA ? h * 64 : 512 + h * 64, kcol = isA ? 256 + (h >> 1) * 64 : 768 + h * 64, vcol = isA ? 384 + (h >> 1) * 64 : 1024 + h * 64, ocol = isA ? h * 64 : 256 + h * 64;
    const int m = lane & 15, quad = lane >> 4;
    const int qpos = q0 + 16 * wave + m, qrow = qrow0 + 16 * wave + m;
    bf16x8 qf[2];
#pragma unroll
    for (int ks = 0; ks < 2; ++ks) qf[ks] = *(const bf16x8*)(H + (size_t)qrow * QKVW + qcol + 32 * ks + 8 * quad);
    constexpr float SC = 0.125f * LOG2E;
    float mrun = isA ? sink[h] * LOG2E : -1e30f, lrun = (isA && quad == 0) ? 1.f : 0.f;
    f32x4 oacc[4];
#pragma unroll
    for (int d = 0; d < 4; ++d) oacc[d] = (f32x4){0.f, 0.f, 0.f, 0.f};
    const int qr = qpos >> 6, qc = qpos & 63;
    const int rs = min(max(qr - 4, 0), 24), cs = min(max(qc - 8, 0), 48);
    int lo = 0, nloc = 0;
    if (kind == 0) { lo = max(0, q0 - 128); const int hi = min(SEQ, q0 + 256); nloc = (hi - lo) >> 6; }
    else if (kind == 1) { const int r0 = q0 >> 6; const int rlo = min(max(r0 - 4, 0), 24), rhi = min(max(r0 - 3, 0), 24) + 8; lo = rlo * 64; nloc = rhi - rlo; }
    __syncthreads();
    if (kind == 1) { for (int i = tid; i < 465; i += 512) rpbs[i] = rpb[h * 465 + i]; }
    const int ntile = 4 + nloc;
    const int lkey = tid >> 3, lch = tid & 7;
    for (int t = 0; t < ntile; ++t) {
        const int krow0 = t < 4 ? NLAT + b * CTXL + 64 * t : b * SEQ + lo + 64 * (t - 4);
        const u32x4 kv = *(const u32x4*)(H + (size_t)(krow0 + lkey) * QKVW + kcol + 8 * lch);
        const u32x4 vv = *(const u32x4*)(H + (size_t)(krow0 + lkey) * QKVW + vcol + 8 * lch);
        __syncthreads();
        *(LAS u32x4*)(Ks + lkey * 144 + 16 * lch) = kv;
#pragma unroll
        for (int i = 0; i < 4; ++i) {
            *(LAS unsigned short*)(Vt + (8 * lch + 2 * i) * 144 + lkey * 2) = (unsigned short)(vv[i] & 0xffffu);
            *(LAS unsigned short*)(Vt + (8 * lch + 2 * i + 1) * 144 + lkey * 2) = (unsigned short)(vv[i] >> 16);
        }
        __syncthreads();
        f32x4 s[4];
#pragma unroll
        for (int kb = 0; kb < 4; ++kb) { s[kb] = (f32x4){0.f, 0.f, 0.f, 0.f};
#pragma unroll
            for (int ks = 0; ks < 2; ++ks) { const bf16x8 af = *(const LAS bf16x8*)(Ks + (16 * kb + m) * 144 + (32 * ks + 8 * quad) * 2);
                s[kb] = __builtin_amdgcn_mfma_f32_16x16x32_bf16(af, qf[ks], s[kb], 0, 0, 0); } }
        if (t < 4 || kind >= 2) {
#pragma unroll
            for (int kb = 0; kb < 4; ++kb) s[kb] = s[kb] * SC;
        } else if (kind == 0) {
            const int kbase = lo + 64 * (t - 4) + 4 * quad;
#pragma unroll
            for (int kb = 0; kb < 4; ++kb)
#pragma unroll
                for (int j = 0; j < 4; ++j) { const int dlt = qpos - (kbase + 16 * kb + j); const bool ok = dlt <= 128 && dlt >= -128; s[kb][j] = ok ? s[kb][j] * SC : -1e30f; }
        } else {
            const int kr = (lo >> 6) + (t - 4); const int dr = kr - rs; const bool rowok = dr >= 0 && dr < 8;
            const int brow = rowok ? (kr - qr + 7) * 31 : 0;
#pragma unroll
            for (int kb = 0; kb < 4; ++kb)
#pragma unroll
                for (int j = 0; j < 4; ++j) { const int kc = 16 * kb + 4 * quad + j; const int dcs = kc - cs; const bool ok = rowok && dcs >= 0 && dcs < 16;
                    const int dc = min(max(kc - qc, -15), 15) + 15; const float bias = rpbs[brow + dc];
                    s[kb][j] = ok ? (s[kb][j] * 0.125f + bias) * LOG2E : -1e30f; }
        }
        float tmax = -1e30f;
#pragma unroll
        for (int kb = 0; kb < 4; ++kb)
#pragma unroll
            for (int j = 0; j < 4; ++j) tmax = fmaxf(tmax, s[kb][j]);
        tmax = fmaxf(tmax, __shfl_xor(tmax, 16)); tmax = fmaxf(tmax, __shfl_xor(tmax, 32));
        const float mnew = fmaxf(mrun, tmax); const float alpha = exp2f(mrun - mnew); mrun = mnew;
        float psum = 0.f;
#pragma unroll
        for (int kb = 0; kb < 4; ++kb)
#pragma unroll
            for (int j = 0; j < 4; ++j) { s[kb][j] = exp2f(s[kb][j] - mnew); psum += s[kb][j]; }
        lrun = lrun * alpha + psum;
#pragma unroll
        for (int d = 0; d < 4; ++d) oacc[d] = oacc[d] * alpha;
#pragma unroll
        for (int ks2 = 0; ks2 < 2; ++ks2) {
            u32x4 pw; pw.x = pk2(s[2 * ks2][0], s[2 * ks2][1]); pw.y = pk2(s[2 * ks2][2], s[2 * ks2][3]); pw.z = pk2(s[2 * ks2 + 1][0], s[2 * ks2 + 1][1]); pw.w = pk2(s[2 * ks2 + 1][2], s[2 * ks2 + 1][3]);
            const bf16x8 pb = __builtin_bit_cast(bf16x8, pw);
#pragma unroll
            for (int db = 0; db < 4; ++db) {
                const u32x2 alo = *(const LAS u32x2*)(Vt + (16 * db + m) * 144 + (32 * ks2 + 4 * quad) * 2);
                const u32x2 ahi = *(const LAS u32x2*)(Vt + (16 * db + m) * 144 + (32 * ks2 + 16 + 4 * quad) * 2);
                u32x4 aw; aw.x = alo.x; aw.y = alo.y; aw.z = ahi.x; aw.w = ahi.y;
                oacc[db] = __builtin_amdgcn_mfma_f32_16x16x32_bf16(__builtin_bit_cast(bf16x8, aw), pb, oacc[db], 0, 0, 0);
            }
        }
    }
    float ltot = lrun + __shfl_xor(lrun, 16); ltot += __shfl_xor(ltot, 32);
    const float inv = 1.f / ltot;
#pragma unroll
    for (int db = 0; db < 4; ++db) { u32x2 w; w.x = pk2(oacc[db][0] * inv, oacc[db][1] * inv); w.y = pk2(oacc[db][2] * inv, oacc[db][3] * inv);
        *(u32x2*)(mix + (size_t)qrow * DM + ocol + 16 * db + 4 * quad) = w; }
}

template <int L>
__device__ __forceinline__ void hyena_unit(LAS unsigned char* lds, int c, const float* Rf, const float* part, int jb0, const bf16_t* hyT, int tok0,
                                           const float* convw, const float* convb, const float* hbias, bf16_t* hyO, int tid, int lane, int wave) {
    constexpr int TPW = L / 128, ST = L / 32, KST = 4 * L + 32, UST = 2 * L + 16, NJB = L / 64, NQ8 = 2 * L / 8;
    LAS unsigned char* Ksh = lds; LAS unsigned char* U = lds + 8 * KST;
    const int m = lane & 15, quad = lane >> 4;
    f32x4 acc[TPW];
#pragma unroll 1
    for (int o = 0; o < 2; ++o) {
        float pv = 0.f;
        if (lane < 2 * NJB) { const int dir = lane / NJB, jb = lane % NJB; pv = part[(jb0 + jb) * 2048 + o * 1024 + dir * 512 + c]; }
        const float inv = 1.f / wave_sum(pv);
        const float dsk = hbias[o * 512 + c];
        const float* R = Rf + ((size_t)(o * 512 + c)) * (2 * L);
        for (int idx = tid; idx < 8 * NQ8; idx += 512) {
            const int e = idx / NQ8, q8 = idx % NQ8; float v[8];
#pragma unroll
            for (int i = 0; i < 8; ++i) { const int p = 8 * q8 + e + i; float x = (p < 2 * L - 1) ? R[p] * inv : 0.f; if (p == L - 1) x += dsk; v[i] = x; }
            u32x4 w; w.x = pk2(v[0], v[1]); w.y = pk2(v[2], v[3]); w.z = pk2(v[4], v[5]); w.w = pk2(v[6], v[7]);
            *(LAS u32x4*)(Ksh + e * KST + q8 * 16) = w;
        }
        if (o == 0) {
            const float w0 = convw[c], w1 = convw[HYW + c], w2 = convw[2 * HYW + c], bb = convb[c];
            for (int idx = tid; idx < 16 * (L / 8); idx += 512) {
                const int b = idx / (L / 8), s = 8 * (idx % (L / 8));
                const bf16_t* base = hyT + (size_t)c * MTOK + tok0 + b * L + s;
                const u32x4 rw = *(const u32x4*)base; float r[10];
                r[0] = s > 0 ? bf2f(base[-1]) : 0.f; r[9] = s + 8 < L ? bf2f(base[8]) : 0.f;
                r[1] = bflo(rw.x); r[2] = bfhi(rw.x); r[3] = bflo(rw.y); r[4] = bfhi(rw.y); r[5] = bflo(rw.z); r[6] = bfhi(rw.z); r[7] = bflo(rw.w); r[8] = bfhi(rw.w);
                float u[8];
#pragma unroll
                for (int i = 0; i < 8; ++i) u[i] = w0 * r[i] + w1 * r[i + 1] + w2 * r[i + 2] + bb;
                u32x4 w; w.x = pk2(u[0], u[1]); w.y = pk2(u[2], u[3]); w.z = pk2(u[4], u[5]); w.w = pk2(u[6], u[7]);
                *(LAS u32x4*)(U + b * UST + s * 2) = w;
            }
        }
        __syncthreads();
#pragma unroll
        for (int ti = 0; ti < TPW; ++ti) acc[ti] = (f32x4){0.f, 0.f, 0.f, 0.f};
        {
            const LAS unsigned char* up = U + m * UST + 16 * quad;
            const LAS unsigned char* kp = Ksh + (7 - (m & 7)) * KST + (L - 8 - 16 * (wave * TPW) - 8 * (m >> 3) + 8 * quad) * 2;
#pragma unroll 2
            for (int si = 0; si < ST; ++si) {
                const bf16x8 bfr = *(const LAS bf16x8*)(up + si * 64);
#pragma unroll
                for (int ti = 0; ti < TPW; ++ti) {
                    const bf16x8 afr = *(const LAS bf16x8*)(kp + si * 64 - ti * 32);
                    acc[ti] = __builtin_amdgcn_mfma_f32_16x16x32_bf16(afr, bfr, acc[ti], 0, 0, 0);
                }
            }
        }
        __syncthreads();
        {
            const int cg2 = (o == 0 ? CWID : 2 * CWID) + c;
            const float w0 = convw[cg2], w1 = convw[HYW + cg2], w2 = convw[2 * HYW + cg2], bb = convb[cg2];
#pragma unroll
            for (int ti = 0; ti < TPW; ++ti) {
                const int t = 16 * (wave * TPW + ti) + 4 * quad;
                const bf16_t* base = hyT + (size_t)cg2 * MTOK + tok0 + m * L + t;
                const u32x2 rw = *(const u32x2*)base; float r[6];
                r[0] = t > 0 ? bf2f(base[-1]) : 0.f; r[5] = t + 4 < L ? bf2f(base[4]) : 0.f;
                r[1] = bflo(rw.x); r[2] = bfhi(rw.x); r[3] = bflo(rw.y); r[4] = bfhi(rw.y);
                float y[4];
#pragma unroll
                for (int i = 0; i < 4; ++i) y[i] = (w0 * r[i] + w1 * r[i + 1] + w2 * r[i + 2] + bb) * acc[ti][i];
                u32x2 w; w.x = pk2(y[0], y[1]); w.y = pk2(y[2], y[3]);
                if (o == 0) *(LAS u32x2*)(U + m * UST + t * 2) = w;
                else *(u32x2*)(hyO + (size_t)c * MTOK + tok0 + m * L + t) = w;
            }
        }
        __syncthreads();
    }
}

__device__ __forceinline__ void mixer_phase(const Args& a, LAS unsigned char* lds, int layer, bool last, int tid, int lane, int wave, int bid, int G) {
    { int t_ = threadIdx.x; asm volatile("" : "+v"(t_)); tid = t_; lane = t_ & 63; wave = __builtin_amdgcn_readfirstlane(t_ >> 6); }
    const bf16_t* H = (const bf16_t*)(a.ws + WS_A2); const bf16_t* hyT = (const bf16_t*)(a.ws + WS_HYT);
    bf16_t* mix = (bf16_t*)(a.ws + WS_A1); bf16_t* hyO = (bf16_t*)(a.ws + WS_HYO);
    const float* part = (const float*)(a.ws + WS_PART) + (size_t)layer * 36 * 2048;
    const float* convw = a.in[I_CONVW] + (size_t)layer * 3 * HYW; const float* convb = a.in[I_CONVB] + (size_t)layer * HYW;
    const float* hbias = a.in[I_HBIAS] + (size_t)layer * 2 * CWID;
    const float* sink = a.in[I_SINK] + layer * 4; const float* rpb = a.in[I_RPB] + (size_t)layer * 4 * 465;
    const int nHL = 512, nHC = last ? 0 : 512, nA0 = 1024, nA1 = 1024, nA2 = last ? 0 : 128, nA3 = last ? 0 : 128;
    const int total = nHL + nHC + nA0 + nA1 + nA2 + nA3;
    for (int u = bid; u < total; u += G) {
        int r = u;
        if (r < nHL) { hyena_unit<2048>(lds, r, (const float*)(a.ws + WS_RFL), part, 0, hyT, 0, convw, convb, hbias, hyO, tid, lane, wave); continue; } r -= nHL;
        if (r < nHC) { hyena_unit<256>(lds, r, (const float*)(a.ws + WS_RFC), part, 32, hyT, NLAT, convw, convb, hbias, hyO, tid, lane, wave); continue; } r -= nHC;
        if (r < nA0) { attn_unit(lds, 0, r >> 6, r & 3, (r >> 2) & 15, H, mix, sink, rpb, tid, lane, wave); continue; } r -= nA0;
        if (r < nA1) { attn_unit(lds, 1, r >> 6, r & 3, (r >> 2) & 15, H, mix, sink, rpb, tid, lane, wave); continue; } r -= nA1;
        if (r < nA2) { attn_unit(lds, 2, r >> 3, r & 3, (r >> 2) & 1, H, mix, sink, rpb, tid, lane, wave); continue; } r -= nA2;
        attn_unit(lds, 3, r >> 3, r & 3, (r >> 2) & 1, H, mix, sink, rpb, tid, lane, wave);
    }
    __syncthreads();
}

__device__ __forceinline__ void hyo_transpose_phase(const Args& a, int ntok, int lane, int wave, int bid, int G) {
    { int t_ = threadIdx.x; asm volatile("" : "+v"(t_)); lane = t_ & 63; wave = __builtin_amdgcn_readfirstlane(t_ >> 6); }
    const int gw = bid * 8 + wave, NGW = G * 8;
    const bf16_t* hyO = (const bf16_t*)(a.ws + WS_HYO); bf16_t* mix = (bf16_t*)(a.ws + WS_A1);
    const int ntb = ntok / 64;
    for (int task = gw; task < ntb * 8; task += NGW) {
        const int tb = task >> 3, cb = task & 7; const int tok = tb * 64 + lane;
        const bf16_t* src = hyO + (size_t)(cb * 64) * MTOK + tok;
        bf16_t* dst = mix + (size_t)tok * DM + CWID + cb * 64;
#pragma unroll
        for (int q = 0; q < 8; ++q) { unsigned v[8];
#pragma unroll
            for (int i = 0; i < 8; ++i) v[i] = src[(size_t)(8 * q + i) * MTOK];
            u32x4 w; w.x = v[0] | (v[1] << 16); w.y = v[2] | (v[3] << 16); w.z = v[4] | (v[5] << 16); w.w = v[6] | (v[7] << 16);
            *(u32x4*)(dst + 8 * q) = w; }
    }
}

__global__ void __launch_bounds__(512, 2) fwd_kernel(Args a) {
    extern __shared__ __attribute__((aligned(16))) unsigned char lds_raw[];
    LAS unsigned char* lds = (LAS unsigned char*)lds_raw;
    cg::grid_group grid = cg::this_grid();
    const int tid = threadIdx.x, lane = tid & 63, wave = __builtin_amdgcn_readfirstlane(tid >> 6), bid = blockIdx.x, G = gridDim.x;
    unsigned char* ws = a.ws;
    float* ctxx = (float*)(ws + WS_CTXX);
    bf16_t* A1 = (bf16_t*)(ws + WS_A1); bf16_t* A2 = (bf16_t*)(ws + WS_A2); bf16_t* hyT = (bf16_t*)(ws + WS_HYT);
    const float* modall = (const float*)(ws + WS_MOD);

#ifndef NO_P0
    phase0(a, lds, tid, lane, wave, bid, G);
#endif
    grid.sync();

    for (int layer = 0; layer < DEPTH; ++layer) {
        const bool last = layer == DEPTH - 1;
        const float* modl = modall + (size_t)layer * 17 * MODW;
        const unsigned char* wl = ws + WS_WT + (size_t)layer * LAYER_W;
        const float* srcL = layer == 0 ? a.in[I_X] : a.out; const float* srcC = layer == 0 ? a.in[I_CTX] : ctxx;
        norm_phase(srcL, srcC, a.in[I_N1G] + layer * DM, modl, 0, DM, A1, MTOK, lane, wave, bid, G);
#ifndef NO_FILT
        if (layer == 0) filter_phase(a, 0, lane, wave, bid, G);
#endif
        grid.sync();
        {
            pg8::Sched2 S; S.A0 = (const char*)A1; S.B0 = (const char*)(wl + W_IN); S.A1 = (const char*)(wl + W_IN) + (size_t)QKVW * DM * 2; S.B1 = (const char*)A1;
            S.nM0 = MTOK / 256; S.nN0 = QKVW / 256; S.nM1 = HYW / 256; S.nN1 = MTOK / 256; S.n0 = S.nM0 * S.nN0; S.n1 = S.nM1 * S.nN1; S.G = G; S.c = bid; S.K = DM;
            pg8::EpiIn E{A2, QKVW, hyT, MTOK};
#ifndef NO_G1
            pg8::gemm_phase<pg8::EpiIn, true>(lds, S, E);
#endif
        }
        grid.sync();
#ifndef NO_POST
        post_phase(a, layer, A2, lane, wave, bid, G);
#endif
        grid.sync();
#ifndef NO_MIX
        mixer_phase(a, lds, layer, last, tid, lane, wave, bid, G);
#endif
        grid.sync();
        hyo_transpose_phase(a, last ? NLAT : MTOK, lane, wave, bid, G);
        grid.sync();
        {
            const int M = last ? NLAT : MTOK;
            pg8::Sched2 S; S.A0 = (const char*)A1; S.B0 = (const char*)(wl + W_OUT); S.A1 = S.A0; S.B1 = S.B0;
            S.nM0 = M / 256; S.nN0 = DM / 256; S.nM1 = 0; S.nN1 = 0; S.n0 = S.nM0 * S.nN0; S.n1 = 0; S.G = G; S.c = bid; S.K = DM;
            pg8::EpiRes E{srcL, srcC, a.out, ctxx, modl + 2 * DM};
#ifndef NO_G2
            pg8::gemm_phase<pg8::EpiRes, true>(lds, S, E);
#endif
        }
        grid.sync();
        norm_phase(a.out, ctxx, a.in[I_N2G] + layer * DM, modl, 3 * DM, 4 * DM, A1, last ? NLAT : MTOK, lane, wave, bid, G);
#ifndef NO_FILT
        if (!last) filter_phase(a, layer + 1, lane, wave, bid, G);
#endif
        grid.sync();
        {
            const int M = last ? NLAT : MTOK;
            pg8::Sched2 S; S.A0 = (const char*)A1; S.B0 = (const char*)(wl + W_GU); S.A1 = S.A0; S.B1 = S.B0;
            S.nM0 = M / 256; S.nN0 = 2 * DFF / 256; S.nM1 = 0; S.nN1 = 0; S.n0 = S.nM0 * S.nN0; S.n1 = 0; S.G = G; S.c = bid; S.K = DM;
            pg8::EpiGU E{A2};
#ifndef NO_G3
            pg8::gemm_phase<pg8::EpiGU, true>(lds, S, E);
#endif
        }
        grid.sync();
        {
            const int M = last ? NLAT : MTOK;
            pg8::Sched2 S; S.A0 = (const char*)A2; S.B0 = (const char*)(wl + W_DN); S.A1 = S.A0; S.B1 = S.B0;
            S.nM0 = M / 256; S.nN0 = DM / 256; S.nM1 = 0; S.nN1 = 0; S.n0 = S.nM0 * S.nN0; S.n1 = 0; S.G = G; S.c = bid; S.K = DFF;
            pg8::EpiRes E{a.out, ctxx, a.out, ctxx, modl + 5 * DM};
#ifndef NO_G2
            pg8::gemm_phase<pg8::EpiRes, true>(lds, S, E);
#endif
        }
        if (!last) grid.sync();
    }
}

extern "C" void kernel_launch(void* const* d_in, const int* in_sizes, int n_in, void* d_out, int out_size, void* d_ws, size_t ws_size, hipStream_t stream) {
    static int grid = 0;
    if (grid == 0) {
        int dev = 0, cus = 0, per_cu = 0;
        hipGetDevice(&dev);
        hipDeviceGetAttribute(&cus, hipDeviceAttributeMultiprocessorCount, dev);
        hipFuncSetAttribute((const void*)fwd_kernel, hipFuncAttributeMaxDynamicSharedMemorySize, LDS_BYTES);
        hipOccupancyMaxActiveBlocksPerMultiprocessor(&per_cu, (const void*)fwd_kernel, 512, LDS_BYTES);
        if (ws_size < WS_END || n_in != 28) { fprintf(stderr, "kernel_launch: unexpected sizes (ws %zu, n_in %d)\n", ws_size, n_in); grid = -1; return; }
        grid = cus > 0 ? cus : 256;
    }
    if (grid < 0) return;
    Args a{};
    for (int i = 0; i < 28; ++i) a.in[i] = (const float*)d_in[i];
    a.out = (float*)d_out; a.ws = (unsigned char*)d_ws;
    void* args[] = {&a};
    hipError_t e = hipLaunchCooperativeKernel((const void*)fwd_kernel, dim3(grid), dim3(512), args, LDS_BYTES, stream);
    if (e != hipSuccess) fprintf(stderr, "cooperative launch failed: %s (grid %d)\n", hipGetErrorString(e), grid);
}
```
